# Optimizing an MI355X kernel written in HIP

```python
import math
import jax, jax.numpy as jnp
from jax import lax
import numpy as np

D_MODEL = 1024
BATCH = 8
SEQ = 2048
DEPTH = 4
DEC_BATCH = 128
DEC_SEQ = 4
PAST_LEN = 16384
PAGE_SIZE = 128

W_A = D_MODEL
N_BLK_A = 8
BLK_A = W_A // N_BLK_A
W_B = D_MODEL
CONV_A = 4
CONV_B = 3
LRU_C = 8.0
ALPHA = (2.0 * DEPTH) ** 0.25
BETA = (8.0 * DEPTH) ** -0.25
LN_EPS = 1e-6
N_IN = 2 * W_A + 4 * W_B + 2 * D_MODEL
SPLITS = (W_A, 2 * W_A, 2 * W_A + W_B, 2 * W_A + 2 * W_B, 2 * W_A + 3 * W_B,
          2 * W_A + 4 * W_B, 2 * W_A + 4 * W_B + D_MODEL)

kernel_name = "hybrid_rglru_shortconv_adaln_deepnorm_step"


def layer_norm(x):
    xf = x.astype(jnp.float32)
    mu = jnp.mean(xf, axis=-1, keepdims=True)
    var = jnp.mean(jnp.square(xf - mu), axis=-1, keepdims=True)
    return (xf - mu) * lax.rsqrt(var + LN_EPS)


def causal_conv(x, buf, w):
    K = w.shape[0]
    T = x.shape[1]
    xp = jnp.concatenate([buf.astype(x.dtype), x], axis=1)
    y = xp[:, 0:T] * w[0]
    for k in range(1, K):
        y = y + xp[:, k:k + T] * w[k]
    return y, xp[:, T:]


def rglru(xa, h0, w_r, b_r, w_i, b_i, lam):
    B, T, _ = xa.shape
    xf = xa.astype(jnp.float32)
    xb = xf.reshape(B, T, N_BLK_A, BLK_A)
    r = jax.nn.sigmoid(jnp.einsum('bthi,hij->bthj', xb, w_r.astype(jnp.float32)).reshape(B, T, W_A) + b_r)
    i = jax.nn.sigmoid(jnp.einsum('bthi,hij->bthj', xb, w_i.astype(jnp.float32)).reshape(B, T, W_A) + b_i)
    log_a = -LRU_C * r * jax.nn.softplus(-lam.astype(jnp.float32))
    a = jnp.exp(log_a)
    mult = jnp.sqrt(-jnp.expm1(2.0 * log_a))
    bterm = mult * (i * xf)
    bterm = bterm.at[:, 0].add(a[:, 0] * h0.astype(jnp.float32))

    def combine(left, right):
        a1, b1 = left
        a2, b2 = right
        return a1 * a2, a2 * b1 + b2

    _, h = lax.associative_scan(combine, (a, bterm), axis=1)
    return h, h[:, -1]


def trunk_layer(x, c, h0, buf_a, buf_b, w_c, b_c, w_in, conv_a_w, conv_a_b, w_r, b_r, w_i, b_i, lam,
                conv_b_w, w_a_out, w_b_out, w_o, ln_g, ln_b):
    dt = x.dtype
    mod = jax.nn.silu(c) @ w_c + b_c
    shift, scale, gate = jnp.split(mod, 3, axis=-1)
    h = (layer_norm(x) * (1.0 + scale[:, None].astype(jnp.float32)) + shift[:, None]).astype(dt)
    u = h @ w_in
    a_x, a_z, b_cg, b_bg, b_x, b_z, g_a, g_b = jnp.split(u, SPLITS, axis=-1)
    xa, new_buf_a = causal_conv(a_x, buf_a, conv_a_w)
    xa = xa + conv_a_b
    hs, h_last = rglru(xa, h0, w_r, b_r, w_i, b_i, lam)
    o_a = (hs.astype(dt) * jax.nn.silu(a_z)) @ w_a_out
    yb, new_buf_b = causal_conv(b_cg * b_x, buf_b, conv_b_w)
    o_b = (b_bg * yb * jax.nn.silu(b_z)) @ w_b_out
    merged = jax.nn.sigmoid(g_a) * o_a + jax.nn.sigmoid(g_b) * o_b
    out = merged @ w_o
    res = ALPHA * x + gate[:, None] * out
    x_new = (layer_norm(res) * ln_g + ln_b).astype(dt)
    return x_new, h_last.astype(dt), new_buf_a, new_buf_b


def setup_inputs(seed: int = 0) -> dict:
    key = jax.random.key(seed)
    ks = jax.random.split(key, 24)
    nrm = jax.random.normal
    f32 = jnp.float32
    a0 = jax.random.uniform(ks[12], (DEPTH, W_A), f32, 0.9, 0.999)
    return {
        "x_prompt": nrm(ks[0], (BATCH, SEQ, D_MODEL), f32),
        "x_sample": nrm(ks[1], (DEC_BATCH, DEC_SEQ, D_MODEL), f32),
        "state_rglru_h": 0.5 * nrm(ks[2], (DEPTH, DEC_BATCH, W_A), f32),
        "state_rglru_conv": nrm(ks[3], (DEPTH, DEC_BATCH, CONV_A - 1, W_A), f32),
        "state_sconv": 0.5 * nrm(ks[4], (DEPTH, DEC_BATCH, CONV_B - 1, W_B), f32),
        "c_prompt": nrm(ks[5], (BATCH, D_MODEL), f32),
        "c_sample": nrm(ks[6], (DEC_BATCH, D_MODEL), f32),
        "w_c": 0.5 * D_MODEL ** -0.5 * nrm(ks[7], (DEPTH, D_MODEL, 3 * D_MODEL), f32),
        "b_c": 0.01 * nrm(ks[8], (DEPTH, 3 * D_MODEL), f32),
        "w_in": D_MODEL ** -0.5 * nrm(ks[9], (DEPTH, D_MODEL, N_IN), f32),
        "conv_a_w": CONV_A ** -0.5 * nrm(ks[10], (DEPTH, CONV_A, W_A), f32),
        "conv_a_b": 0.01 * nrm(ks[11], (DEPTH, W_A), f32),
        "w_r": BLK_A ** -0.5 * nrm(ks[13], (DEPTH, N_BLK_A, BLK_A, BLK_A), f32),
        "b_r": 0.01 * nrm(ks[14], (DEPTH, W_A), f32),
        "w_i": BLK_A ** -0.5 * nrm(ks[15], (DEPTH, N_BLK_A, BLK_A, BLK_A), f32),
        "b_i": 0.01 * nrm(ks[16], (DEPTH, W_A), f32),
        "lru_lambda": jnp.log(a0) - jnp.log1p(-a0),
        "conv_b_w": CONV_B ** -0.5 * nrm(ks[17], (DEPTH, CONV_B, W_B), f32),
        "w_a_out": BETA * W_A ** -0.5 * nrm(ks[18], (DEPTH, W_A, D_MODEL), f32),
        "w_b_out": BETA * W_B ** -0.5 * nrm(ks[19], (DEPTH, W_B, D_MODEL), f32),
        "w_o": BETA * D_MODEL ** -0.5 * nrm(ks[20], (DEPTH, D_MODEL, D_MODEL), f32),
        "ln_g": 1.0 + 0.05 * nrm(ks[21], (DEPTH, D_MODEL), f32),
        "ln_b": 0.01 * nrm(ks[22], (DEPTH, D_MODEL), f32),
    }


def reference(x_prompt, x_sample, state_rglru_h, state_rglru_conv, state_sconv, c_prompt, c_sample,
              w_c, b_c, w_in, conv_a_w, conv_a_b, w_r, b_r, w_i, b_i, lru_lambda, conv_b_w,
              w_a_out, w_b_out, w_o, ln_g, ln_b):
    dt = x_prompt.dtype
    bp = x_prompt.shape[0]
    xp, xs = x_prompt, x_sample
    hp_list, cap_list, cbp_list = [], [], []
    hs_list, cas_list, cbs_list = [], [], []
    for l in range(DEPTH):
        params = (w_c[l], b_c[l], w_in[l], conv_a_w[l], conv_a_b[l], w_r[l], b_r[l], w_i[l], b_i[l],
                  lru_lambda[l], conv_b_w[l], w_a_out[l], w_b_out[l], w_o[l], ln_g[l], ln_b[l])
        h0p = jnp.zeros((bp, W_A), dt)
        bufa_p = jnp.zeros((bp, CONV_A - 1, W_A), dt)
        bufb_p = jnp.zeros((bp, CONV_B - 1, W_B), dt)
        xp, hp, cap, cbp = trunk_layer(xp, c_prompt, h0p, bufa_p, bufb_p, *params)
        xs, hs, cas, cbs = trunk_layer(xs, c_sample, state_rglru_h[l], state_rglru_conv[l], state_sconv[l], *params)
        hp_list.append(hp); cap_list.append(cap); cbp_list.append(cbp)
        hs_list.append(hs); cas_list.append(cas); cbs_list.append(cbs)
    h_prompt = jnp.stack(hp_list)
    conv_a_prompt = jnp.stack(cap_list)
    conv_b_prompt = jnp.stack(cbp_list)
    h_sample = jnp.stack(hs_list)
    conv_a_sample = jnp.stack(cas_list)
    conv_b_sample = jnp.stack(cbs_list)
    return (xp, xs, h_prompt, conv_a_prompt, conv_b_prompt, h_sample, conv_a_sample, conv_b_sample)
```

```cpp
#include <hip/hip_runtime.h>
#include <cstdio>
#include <cstdint>

#ifndef MK_ONE_LAUNCH
#define MK_ONE_LAUNCH 0
#endif

#define LAS __attribute__((address_space(3)))
#define GAS __attribute__((address_space(1)))
typedef unsigned short bf16_t;
typedef short bf16x8 __attribute__((ext_vector_type(8)));
typedef float f32x4 __attribute__((ext_vector_type(4)));
typedef float f32x16 __attribute__((ext_vector_type(16)));
typedef unsigned u32x4 __attribute__((ext_vector_type(4)));
typedef unsigned u32x2 __attribute__((ext_vector_type(2)));

constexpr int D = 1024, NB = 8, SEQ = 2048, DEPTH = 4, NQ = 128, DSEQ = 4;
constexpr int MP = NB * SEQ;
constexpr int MS = NQ * DSEQ;
constexpr int M = MP + MS;
constexpr int NIN = 8192;
constexpr float ALPHA = 1.681792830507429f;
constexpr float LN_EPS = 1e-6f;
constexpr float LOG2E = 1.4426950408889634f;

constexpr size_t MiB = 1u << 20;
constexpr size_t WS_CTL = 0, CTL_ZERO_BYTES = 1 * MiB;
constexpr size_t WS_CS = 1 * MiB;
constexpr size_t WS_MOD = 2 * MiB;
constexpr size_t WS_WRI = 14 * MiB;
constexpr size_t WS_WC = 16 * MiB;
constexpr size_t WS_WIN = 40 * MiB;
constexpr size_t WS_WA = 104 * MiB, WS_WB = 112 * MiB, WS_WO = 120 * MiB;
constexpr size_t WS_H = 128 * MiB;
constexpr size_t ACT_BYTES = (size_t)M * D * 2;
constexpr size_t WS_U = 162 * MiB;
constexpr size_t WS_T = 360 * MiB;
constexpr size_t WS_END = 424 * MiB;
static_assert(ACT_BYTES == 33 * MiB, "act bytes");

constexpr size_t O_Y = 0;
constexpr size_t O_HP = (size_t)M * D;
constexpr size_t O_CAP = O_HP + (size_t)DEPTH * NB * D;
constexpr size_t O_CBP = O_CAP + (size_t)DEPTH * NB * 3 * D;
constexpr size_t O_HS = O_CBP + (size_t)DEPTH * NB * 2 * D;
constexpr size_t O_CAS = O_HS + (size_t)DEPTH * NQ * D;
constexpr size_t O_CBS = O_CAS + (size_t)DEPTH * NQ * 3 * D;
constexpr size_t O_END = O_CBS + (size_t)DEPTH * NQ * 2 * D;
static_assert(O_END == 20643840, "output size");

constexpr int NWAVES = 8;
constexpr int LDS_BYTES = 147456;

__device__ __forceinline__ unsigned f2bf(float f) { unsigned u = __builtin_bit_cast(unsigned, f); return (u + 0x7fffu + ((u >> 16) & 1u)) >> 16; }
__device__ __forceinline__ unsigned pk2(float lo, float hi) { return f2bf(lo) | (f2bf(hi) << 16); }
__device__ __forceinline__ unsigned cvt_pk_bf16(float lo, float hi) { unsigned r; asm volatile("v_cvt_pk_bf16_f32 %0, %1, %2" : "=v"(r) : "v"(lo), "v"(hi)); return r; }
__device__ __forceinline__ float bf_lo(unsigned w) { return __builtin_bit_cast(float, w << 16); }
__device__ __forceinline__ float bf_hi(unsigned w) { return __builtin_bit_cast(float, w & 0xffff0000u); }
__device__ __forceinline__ float sigmoid_f(float x) { return __builtin_amdgcn_rcpf(1.0f + __builtin_amdgcn_exp2f(-LOG2E * x)); }
__device__ __forceinline__ float silu_f(float x) { return x * sigmoid_f(x); }
__device__ __forceinline__ float wave_sum(float v) {
#pragma unroll
    for (int o = 1; o < 64; o <<= 1) v += __shfl_xor(v, o);
    return v;
}
#define LDS_WAIT() asm volatile("s_waitcnt lgkmcnt(0)" ::: "memory")
#define VM_WAIT() asm volatile("s_waitcnt vmcnt(0)" ::: "memory")

namespace pg8 {
constexpr int BM = 256, BK = 64, HALF = 128, HTB = HALF * BK * 2, STAGE_BYTES = 8 * HTB, NXCD = 8, WGM = 8;
__host__ __device__ __forceinline__ int lds_byte(int r, int c) { const int st = (r >> 4) * 2 + (c >> 5), rr = r & 15, cc = c & 31, ob = rr * 64 + cc * 2; return st * 1024 + (ob ^ (((ob >> 9) & 1) << 5)); }
__host__ __device__ __forceinline__ void stage_rc(int b, int& R, int& C) { const int st = b / 1024, sb = b % 1024, swz = sb ^ (((sb >> 9) & 1) << 5); R = (st >> 1) * 16 + swz / 64; C = (st & 1) * 32 + (swz % 64) / 2; }
__host__ __device__ __forceinline__ int perm32(int rho) { const int n = rho >> 4, i = rho & 15; return 8 * (i >> 2) + 4 * n + (i & 3); }

struct Unit { int pm, pn, kind; };
struct Gemm { const bf16_t *A0, *A1, *B0, *B1; int lda, ldb, K; };

struct StaticOrder {
    int nM, nN, nwg, G, c, NK;
    __device__ void init(int Mr, int N, int G_, int c_, int NK_) { nM = Mr / BM; nN = N / BM; nwg = nM * nN; G = G_; c = c_; NK = NK_; }
    __device__ bool next(int i, Unit& u) const {
        const int ti = i / NK; u.kind = i - ti * NK;
        const long L = (long)ti * G + c; if (L >= nwg) return false;
        int wgid = (int)L; { const int q = nwg / NXCD, r = nwg % NXCD, xcd = wgid % NXCD, off = wgid / NXCD; wgid = (xcd < r ? xcd * (q + 1) : r * (q + 1) + (xcd - r) * q) + off; }
        const int nig = WGM * nN, gid = wgid / nig, fm = gid * WGM, gsz = (nM - fm) < WGM ? (nM - fm) : WGM;
        u.pm = fm + ((wgid % nig) % gsz); u.pn = (wgid % nig) / gsz; return true;
    }
};

template <class Epi, bool ALIGN_EPI, bool SP2>
__device__ __forceinline__ void gemm_phase(LAS unsigned char* lds, const Gemm g, const StaticOrder& S, const Epi& E, const int tid) {
    const int wid = __builtin_amdgcn_readfirstlane(tid >> 6), lane = tid & 63, wr = wid >> 2, wc = wid & 3, fr = lane & 15, fq = lane >> 4;
    const int nt = g.K / BK;
    unsigned voffA[2], voffB[2];
#pragma unroll
    for (int i = 0; i < 2; ++i) { int R, C; stage_rc(tid * 16 + i * 8192, R, C); const int Rb = Epi::PERM ? ((R & ~31) + perm32(R & 31)) : R;
        voffA[i] = (unsigned)(R * g.lda + C) * 2u; voffB[i] = (unsigned)(Rb * g.ldb + C) * 2u; }
    const size_t kstep = (size_t)(BK * 2);
    const size_t hstepA = (size_t)HALF * g.lda * 2, hstepB = (size_t)HALF * g.ldb * 2;
    const size_t tstepA = 2 * hstepA, tstepB = 2 * hstepB;
    const unsigned ldsw = (unsigned)wid * 1024u;
    const int aoff = lds_byte(wr * 64 + fr, fq * 8), boff = lds_byte(wc * 32 + fr, fq * 8);
#define PG8_SA(b, h) (((b) * 2 + (h)) * HTB)
#define PG8_SB(b, h) ((4 + (b) * 2 + (h)) * HTB)
#define PG8_STAGE(bufoff, gbase, voff) do { _Pragma("unroll") for (int _i = 0; _i < 2; ++_i) \
        __builtin_amdgcn_global_load_lds((const unsigned*)((const char*)(gbase) + (voff)[_i]), (LAS unsigned*)(lds + (bufoff) + ldsw + _i * 8192), 16, 0, 0); } while (0)
#define PG8_LDA(dst, b, h) do { _Pragma("unroll") for (int m = 0; m < 4; ++m) _Pragma("unroll") for (int k = 0; k < 2; ++k) dst[m][k] = *(const LAS bf16x8*)(lds + PG8_SA(b, h) + aoff + m * 2048 + k * 1024); } while (0)
#define PG8_LDB(dst, b, h) do { _Pragma("unroll") for (int n = 0; n < 2; ++n) _Pragma("unroll") for (int k = 0; k < 2; ++k) dst[n][k] = *(const LAS bf16x8*)(lds + PG8_SB(b, h) + boff + n * 2048 + k * 1024); } while (0)
#define PG8_MMA(ai, bj, At, Bt) do { __builtin_amdgcn_s_setprio(1); _Pragma("unroll") for (int m = 0; m < 4; ++m) _Pragma("unroll") for (int n = 0; n < 2; ++n) _Pragma("unroll") for (int k = 0; k < 2; ++k) \
        acc[ai][bj][m][n] = __builtin_amdgcn_mfma_f32_16x16x32_bf16(Bt[n][k], At[m][k], acc[ai][bj][m][n], 0, 0, 0); __builtin_amdgcn_s_setprio(0); } while (0)
#define PG8_WAIT_V(n) asm volatile("s_waitcnt vmcnt(" #n ")" ::: "memory")
#define PG8_WAIT_L(n) asm volatile("s_waitcnt lgkmcnt(" #n ")" ::: "memory")
#define PG8_BAR __builtin_amdgcn_s_barrier()
#define PG8_SCHED __builtin_amdgcn_sched_barrier(0)
    Unit cur, nxt; int ui = 0;
    if (!S.next(0, cur)) return;
    f32x4 acc[2][2][4][2];
#pragma unroll
    for (int a = 0; a < 2; ++a)
#pragma unroll
        for (int b = 0; b < 2; ++b)
#pragma unroll
            for (int m = 0; m < 4; ++m)
#pragma unroll
                for (int n = 0; n < 2; ++n) acc[a][b][m][n] = (f32x4){0.f, 0.f, 0.f, 0.f};
    bf16x8 At[4][2], B0[2][2], B1[2][2];
    const char* cA = (const char*)(cur.kind ? g.A1 : g.A0) + (size_t)cur.pm * tstepA; const char* cB = (const char*)(cur.kind ? g.B1 : g.B0) + (size_t)cur.pn * tstepB;
    if constexpr (SP2) {
        PG8_STAGE(PG8_SB(0, 0), cB, voffB); PG8_STAGE(PG8_SB(0, 1), cB + hstepB, voffB); PG8_STAGE(PG8_SA(0, 0), cA, voffA); PG8_STAGE(PG8_SA(0, 1), cA + hstepA, voffA);
        if (wr == 1) PG8_BAR;
        PG8_WAIT_V(2); PG8_BAR;
        PG8_STAGE(PG8_SB(1, 0), cB + kstep, voffB); PG8_STAGE(PG8_SA(1, 0), cA + kstep, voffA); PG8_STAGE(PG8_SB(1, 1), cB + hstepB + kstep, voffB);
        PG8_WAIT_V(6); PG8_BAR;
    } else {
        PG8_STAGE(PG8_SB(0, 0), cB, voffB); PG8_STAGE(PG8_SA(0, 0), cA, voffA); PG8_STAGE(PG8_SB(0, 1), cB + hstepB, voffB); PG8_STAGE(PG8_SA(0, 1), cA + hstepA, voffA);
        if (wr == 1) PG8_BAR;
        PG8_WAIT_V(4); PG8_BAR;
        PG8_STAGE(PG8_SB(1, 0), cB + kstep, voffB); PG8_STAGE(PG8_SA(1, 0), cA + kstep, voffA); PG8_STAGE(PG8_SB(1, 1), cB + hstepB + kstep, voffB);
        PG8_WAIT_V(6); PG8_BAR;
    }
    for (;;) {
        const bool has_next = S.next(ui + 1, nxt);
        const char* nA = has_next ? (const char*)(nxt.kind ? g.A1 : g.A0) + (size_t)nxt.pm * tstepA : cA; const char* nB = has_next ? (const char*)(nxt.kind ? g.B1 : g.B0) + (size_t)nxt.pn * tstepB : cB;
        for (int t = 0; t < nt; t += 2) {
            const bool last = (t == nt - 2);
            const char* a1 = cA + (size_t)(t + 1) * kstep;
            const char* a2 = last ? nA : cA + (size_t)(t + 2) * kstep; const char* b2 = last ? nB : cB + (size_t)(t + 2) * kstep;
            const char* a3 = a2 + kstep; const char* b3 = b2 + kstep;
            if constexpr (SP2) {
            PG8_LDB(B0, 0, 0); PG8_LDB(B1, 0, 1); PG8_SCHED; PG8_LDA(At, 0, 0); PG8_STAGE(PG8_SA(1, 1), a1 + hstepA, voffA);
            PG8_WAIT_V(8); PG8_WAIT_L(0); PG8_BAR; PG8_MMA(0, 0, At, B0); PG8_MMA(0, 1, At, B1); PG8_BAR; PG8_SCHED;
            PG8_LDA(At, 0, 1); PG8_STAGE(PG8_SB(0, 0), b2, voffB); PG8_STAGE(PG8_SB(0, 1), b2 + hstepB, voffB); PG8_STAGE(PG8_SA(0, 0), a2, voffA);
            PG8_WAIT_V(8); PG8_WAIT_L(0); PG8_BAR; PG8_MMA(1, 0, At, B0); PG8_MMA(1, 1, At, B1); PG8_BAR; PG8_SCHED;
            PG8_LDB(B0, 1, 0); PG8_LDB(B1, 1, 1); PG8_SCHED; PG8_LDA(At, 1, 0); PG8_STAGE(PG8_SA(0, 1), a2 + hstepA, voffA);
            PG8_WAIT_V(8); PG8_WAIT_L(0); PG8_BAR; PG8_MMA(0, 0, At, B0); PG8_MMA(0, 1, At, B1); PG8_BAR; PG8_SCHED;
            PG8_LDA(At, 1, 1); PG8_STAGE(PG8_SB(1, 0), b3, voffB); PG8_STAGE(PG8_SB(1, 1), b3 + hstepB, voffB); PG8_STAGE(PG8_SA(1, 0), a3, voffA);
            PG8_WAIT_V(8); PG8_WAIT_L(0); PG8_BAR; PG8_MMA(1, 0, At, B0); PG8_MMA(1, 1, At, B1); PG8_BAR; PG8_SCHED;
            } else {
            PG8_LDB(B0, 0, 0); PG8_SCHED; PG8_LDA(At, 0, 0); PG8_STAGE(PG8_SA(1, 1), a1 + hstepA, voffA);
            PG8_WAIT_L(8); PG8_BAR; PG8_WAIT_L(0); PG8_MMA(0, 0, At, B0); PG8_BAR; PG8_SCHED;
            PG8_LDB(B1, 0, 1); PG8_STAGE(PG8_SB(0, 0), b2, voffB);
            PG8_BAR; PG8_WAIT_L(0); PG8_MMA(0, 1, At, B1); PG8_BAR;
            PG8_LDA(At, 0, 1); PG8_STAGE(PG8_SA(0, 0), a2, voffA);
            PG8_BAR; PG8_WAIT_L(0); PG8_MMA(1, 0, At, B0); PG8_BAR; PG8_SCHED;
            PG8_STAGE(PG8_SB(0, 1), b2 + hstepB, voffB);
            PG8_WAIT_V(6); PG8_BAR; PG8_MMA(1, 1, At, B1); PG8_BAR;
            PG8_LDB(B0, 1, 0); PG8_SCHED; PG8_LDA(At, 1, 0); PG8_STAGE(PG8_SA(0, 1), a2 + hstepA, voffA);
            PG8_WAIT_L(8); PG8_BAR; PG8_WAIT_L(0); PG8_MMA(0, 0, At, B0); PG8_BAR; PG8_SCHED;
            PG8_LDB(B1, 1, 1); PG8_STAGE(PG8_SB(1, 0), b3, voffB);
            PG8_BAR; PG8_WAIT_L(0); PG8_MMA(0, 1, At, B1); PG8_BAR;
            PG8_LDA(At, 1, 1); PG8_STAGE(PG8_SA(1, 0), a3, voffA);
            PG8_BAR; PG8_WAIT_L(0); PG8_MMA(1, 0, At, B0); PG8_BAR; PG8_SCHED;
            PG8_STAGE(PG8_SB(1, 1), b3 + hstepB, voffB);
            PG8_WAIT_V(6); PG8_BAR; PG8_MMA(1, 1, At, B1); PG8_BAR;
            }
        }
        if constexpr (ALIGN_EPI) { if (wr == 0) PG8_BAR; }
        const bool keep = E(acc, cur, wr, wc, fr, fq);
        if (!has_next) break;
        if (!keep) {
#pragma unroll
        for (int a = 0; a < 2; ++a)
#pragma unroll
            for (int b = 0; b < 2; ++b)
#pragma unroll
                for (int m = 0; m < 4; ++m)
#pragma unroll
                    for (int n = 0; n < 2; ++n) acc[a][b][m][n] = (f32x4){0.f, 0.f, 0.f, 0.f};
        }
        cur = nxt; cA = nA; cB = nB; ++ui;
        if constexpr (ALIGN_EPI) { if (wr == 1) PG8_BAR; }
    }
    PG8_WAIT_V(0);
    if constexpr (!ALIGN_EPI) { if (wr == 0) PG8_BAR; }
    PG8_BAR;
#undef PG8_SA
#undef PG8_SB
#undef PG8_STAGE
#undef PG8_LDA
#undef PG8_LDB
#undef PG8_MMA
#undef PG8_WAIT_V
#undef PG8_WAIT_L
#undef PG8_BAR
#undef PG8_SCHED
}
}

using pg8::Unit;
using pg8::HALF;

struct EpiMod {
    static constexpr bool PERM = false;
    float* C; int ldc; const float* bias;
    __device__ __forceinline__ bool operator()(f32x4 (&acc)[2][2][4][2], const Unit& u, int wr, int wc, int fr, int fq) const {
        const int row0 = u.pm * 256 + wr * 64 + fr, col0 = u.pn * 256 + wc * 32 + 4 * fq;
#pragma unroll
        for (int bj = 0; bj < 2; ++bj)
#pragma unroll
            for (int n = 0; n < 2; ++n) {
                const f32x4 bv = *(const f32x4*)(bias + col0 + bj * HALF + n * 16);
#pragma unroll
                for (int ai = 0; ai < 2; ++ai)
#pragma unroll
                    for (int m = 0; m < 4; ++m) *(f32x4*)(C + (size_t)(row0 + ai * HALF + m * 16) * ldc + col0 + bj * HALF + n * 16) = acc[ai][bj][m][n] + bv;
            }
        return false;
    }
};

struct EpiG1 {
    static constexpr bool PERM = true;
    bf16_t *AX, *SAZ, *V, *WG, *SGA, *SGB;
    float *ca_p, *cb_p, *ca_s, *cb_s;
    __device__ __forceinline__ bool operator()(f32x4 (&acc)[2][2][4][2], const Unit& u, int wr, int wc, int fr, int fq) const {
        const int row0 = u.pm * 256 + wr * 64 + fr, ch0 = u.pn * 32 + 8 * fq;
#pragma unroll
        for (int ai = 0; ai < 2; ++ai)
#pragma unroll
            for (int m = 0; m < 4; ++m) {
                const int r = row0 + ai * HALF + m * 16;
                const f32x4 p0 = acc[ai][0][m][0], p1 = acc[ai][0][m][1], q0 = acc[ai][1][m][0], q1 = acc[ai][1][m][1];
                const size_t off = (size_t)r * D + ch0;
                if (wc == 0) {
                    const f32x4 v0 = p0 * q0, v1 = p1 * q1;
                    u32x4 w; w.x = cvt_pk_bf16(v0[0], v0[1]); w.y = cvt_pk_bf16(v0[2], v0[3]); w.z = cvt_pk_bf16(v1[0], v1[1]); w.w = cvt_pk_bf16(v1[2], v1[3]);
                    *(u32x4*)(V + off) = w;
                    if (r < MP) { const int t = r & (SEQ - 1); if (t >= SEQ - 2) { float* o = cb_p + ((size_t)(r >> 11) * 2 + (t - (SEQ - 2))) * D + ch0; *(f32x4*)o = v0; *(f32x4*)(o + 4) = v1; } }
                    else { const int rs = r - MP, t = rs & 3; if (t >= 2) { float* o = cb_s + ((size_t)(rs >> 2) * 2 + (t - 2)) * D + ch0; *(f32x4*)o = v0; *(f32x4*)(o + 4) = v1; } }
                } else if (wc == 1) {
                    f32x4 v0, v1;
#pragma unroll
                    for (int j = 0; j < 4; ++j) { v0[j] = p0[j] * silu_f(q0[j]); v1[j] = p1[j] * silu_f(q1[j]); }
                    u32x4 w; w.x = cvt_pk_bf16(v0[0], v0[1]); w.y = cvt_pk_bf16(v0[2], v0[3]); w.z = cvt_pk_bf16(v1[0], v1[1]); w.w = cvt_pk_bf16(v1[2], v1[3]);
                    *(u32x4*)(WG + off) = w;
                } else if (wc == 2) {
                    u32x4 w; w.x = cvt_pk_bf16(p0[0], p0[1]); w.y = cvt_pk_bf16(p0[2], p0[3]); w.z = cvt_pk_bf16(p1[0], p1[1]); w.w = cvt_pk_bf16(p1[2], p1[3]);
                    *(u32x4*)(AX + off) = w;
                    f32x4 v0, v1;
#pragma unroll
                    for (int j = 0; j < 4; ++j) { v0[j] = silu_f(q0[j]); v1[j] = silu_f(q1[j]); }
                    u32x4 w2; w2.x = cvt_pk_bf16(v0[0], v0[1]); w2.y = cvt_pk_bf16(v0[2], v0[3]); w2.z = cvt_pk_bf16(v1[0], v1[1]); w2.w = cvt_pk_bf16(v1[2], v1[3]);
                    *(u32x4*)(SAZ + off) = w2;
                    if (r < MP) { const int t = r & (SEQ - 1); if (t >= SEQ - 3) { float* o = ca_p + ((size_t)(r >> 11) * 3 + (t - (SEQ - 3))) * D + ch0; *(f32x4*)o = p0; *(f32x4*)(o + 4) = p1; } }
                    else { const int rs = r - MP, t = rs & 3; if (t >= 1) { float* o = ca_s + ((size_t)(rs >> 2) * 3 + (t - 1)) * D + ch0; *(f32x4*)o = p0; *(f32x4*)(o + 4) = p1; } }
                } else {
                    f32x4 v0, v1, z0, z1;
#pragma unroll
                    for (int j = 0; j < 4; ++j) { v0[j] = sigmoid_f(p0[j]); v1[j] = sigmoid_f(p1[j]); z0[j] = sigmoid_f(q0[j]); z1[j] = sigmoid_f(q1[j]); }
                    u32x4 w; w.x = cvt_pk_bf16(v0[0], v0[1]); w.y = cvt_pk_bf16(v0[2], v0[3]); w.z = cvt_pk_bf16(v1[0], v1[1]); w.w = cvt_pk_bf16(v1[2], v1[3]);
                    *(u32x4*)(SGA + off) = w;
                    u32x4 w2; w2.x = cvt_pk_bf16(z0[0], z0[1]); w2.y = cvt_pk_bf16(z0[2], z0[3]); w2.z = cvt_pk_bf16(z1[0], z1[1]); w2.w = cvt_pk_bf16(z1[2], z1[3]);
                    *(u32x4*)(SGB + off) = w2;
                }
            }
        return false;
    }
};

struct EpiG3 {
    static constexpr bool PERM = true;
    const bf16_t *SGA, *SGB; bf16_t* MG;
    __device__ __forceinline__ bool operator()(f32x4 (&acc)[2][2][4][2], const Unit& u, int wr, int wc, int fr, int fq) const {
        const int row0 = u.pm * 256 + wr * 64 + fr, col0 = u.pn * 256 + wc * 32 + 8 * fq;
#pragma unroll
        for (int ai = 0; ai < 2; ++ai)
#pragma unroll
            for (int m = 0; m < 4; ++m)
#pragma unroll
                for (int bj = 0; bj < 2; ++bj) {
                    const size_t off = (size_t)(row0 + ai * HALF + m * 16) * D + col0 + bj * HALF;
                    const u32x4 sb = *(const u32x4*)(SGB + off);
                    float b[8] = {bf_lo(sb.x), bf_hi(sb.x), bf_lo(sb.y), bf_hi(sb.y), bf_lo(sb.z), bf_hi(sb.z), bf_lo(sb.w), bf_hi(sb.w)};
#pragma unroll
                    for (int j = 0; j < 8; ++j) b[j] = fmaxf(b[j], 1e-20f);
                    if (u.kind == 0) {
                        const u32x4 sa = *(const u32x4*)(SGA + off);
                        const float a[8] = {bf_lo(sa.x), bf_hi(sa.x), bf_lo(sa.y), bf_hi(sa.y), bf_lo(sa.z), bf_hi(sa.z), bf_lo(sa.w), bf_hi(sa.w)};
#pragma unroll
                        for (int j = 0; j < 4; ++j) { acc[ai][bj][m][0][j] *= a[j] * __builtin_amdgcn_rcpf(b[j]); acc[ai][bj][m][1][j] *= a[4 + j] * __builtin_amdgcn_rcpf(b[4 + j]); }
                    } else {
                        const f32x4 v0 = acc[ai][bj][m][0], v1 = acc[ai][bj][m][1];
                        u32x4 w; w.x = cvt_pk_bf16(v0[0] * b[0], v0[1] * b[1]); w.y = cvt_pk_bf16(v0[2] * b[2], v0[3] * b[3]); w.z = cvt_pk_bf16(v1[0] * b[4], v1[1] * b[5]); w.w = cvt_pk_bf16(v1[2] * b[6], v1[3] * b[7]);
                        *(u32x4*)(MG + off) = w;
                    }
                    asm volatile("" ::: "memory");
                }
        return u.kind == 0;
    }
};

struct EpiG4 {
    static constexpr bool PERM = false;
    const float *Xp, *Xs;
    const float* gate;
    float* RES;
    __device__ __forceinline__ bool operator()(f32x4 (&acc)[2][2][4][2], const Unit& u, int wr, int wc, int fr, int fq) const {
        const int row0 = u.pm * 256 + wr * 64 + fr, col0 = u.pn * 256 + wc * 32 + 4 * fq;
        const bool prompt = (u.pm < MP / 256);
#pragma unroll
        for (int ai = 0; ai < 2; ++ai)
#pragma unroll
            for (int m = 0; m < 4; ++m) {
                const int r = row0 + ai * HALF + m * 16;
                const float* xr = prompt ? Xp + (size_t)r * D : Xs + (size_t)(r - MP) * D;
                const int mrow = prompt ? (r >> 11) : (NB + ((r - MP) >> 2));
                const float* gr = gate + (size_t)mrow * 12288;
#pragma unroll
                for (int bj = 0; bj < 2; ++bj)
#pragma unroll
                    for (int n = 0; n < 2; ++n) {
                        const int c = col0 + bj * HALF + n * 16;
                        const f32x4 xv = *(const f32x4*)(xr + c), gv = *(const f32x4*)(gr + c);
                        *(f32x4*)(RES + (size_t)r * D + c) = ALPHA * xv + gv * acc[ai][bj][m][n];
                    }
            }
        return false;
    }
};

#define XB_TMO      128
#define XB_XCNT(j)  (256  + 64 * (j))
#define XB_XSUB(j)  (1280 + 64 * (j))
#define XB_XGEN(j)  (2304 + 64 * (j))
#define XB_TOP      3328
#define XB_TOPGEN   3392
#define XCD_BAR_WORDS 3456
#define XB_SPIN_CAP (1u << 18)
__device__ __forceinline__ unsigned xb_ld(unsigned* p)              { return __hip_atomic_load(p, __ATOMIC_RELAXED, __HIP_MEMORY_SCOPE_AGENT); }
__device__ __forceinline__ unsigned xb_add(unsigned* p, unsigned v) { return __hip_atomic_fetch_add(p, v, __ATOMIC_RELAXED, __HIP_MEMORY_SCOPE_AGENT); }
__device__ __forceinline__ unsigned xb_xcc_id() { return (unsigned)__builtin_amdgcn_s_getreg((3 << 11) | 20) & 0xFu; }
#define XB_SPIN(cond, bar) do { unsigned _sp = 0; while (cond) { __builtin_amdgcn_s_sleep(1); \
    if ((++_sp & 255u) == 0u) { if (xb_ld(&(bar)[XB_TMO])) break; if (_sp > XB_SPIN_CAP) { atomicAdd(&(bar)[XB_TMO], 1u); break; } } } } while (0)
struct XcdBarrier { unsigned* bar; unsigned x; volatile LAS unsigned* st; };
__device__ __forceinline__ XcdBarrier xcd_barrier_post(unsigned* bar, volatile LAS unsigned* st) {
    XcdBarrier b; b.bar = bar; b.x = xb_xcc_id(); b.st = st;
    if (threadIdx.x == 0) (void)xb_add(&bar[XB_XCNT(b.x)], 1u);
    return b;
}
__device__ __forceinline__ void xcd_barrier_complete(unsigned* bar, unsigned x, unsigned& nloc, unsigned& nx) {
    const unsigned G = gridDim.x * gridDim.y * gridDim.z;
    unsigned sum, cnt, mine, sp = 0u;
    for (;;) {
        sum = 0u; cnt = 0u; mine = 0u;
#pragma unroll
        for (unsigned j = 0; j < 16; ++j) { const unsigned c = xb_ld(&bar[XB_XCNT(j)]); sum += c; cnt += (c > 0u) ? 1u : 0u; mine = (j == x) ? c : mine; }
        if (sum == G) break;
        __builtin_amdgcn_s_sleep(1);
        if ((++sp & 255u) == 0u) { if (xb_ld(&bar[XB_TMO])) break; if (sp > XB_SPIN_CAP) { atomicAdd(&bar[XB_TMO], 1u); break; } }
    }
    nloc = mine > 0u ? mine : 1u; nx = cnt > 0u ? cnt : 1u;
}
__device__ __forceinline__ void xcd_barrier(const XcdBarrier& b) {
    asm volatile("s_waitcnt vmcnt(0)" ::: "memory");
    __syncthreads();
    if (threadIdx.x == 0) {
        unsigned* bar = b.bar;
        __builtin_amdgcn_s_waitcnt(0);
        unsigned nloc = b.st[0], nx = b.st[1];
        if (nloc == 0u) { xcd_barrier_complete(bar, b.x, nloc, nx); b.st[0] = nloc; b.st[1] = nx; }
        const unsigned old = xb_add(&bar[XB_XSUB(b.x)], 1u);
        const unsigned gen = old / nloc;
        if (old + 1u == (gen + 1u) * nloc) {
            __builtin_amdgcn_fence(__ATOMIC_RELEASE, "agent");
            asm volatile("s_waitcnt vmcnt(0)" ::: "memory");
            const unsigned og = xb_add(&bar[XB_TOP], 1u);
            const unsigned tg = og / nx;
            if (og + 1u == (tg + 1u) * nx) xb_add(&bar[XB_TOPGEN], 1u);
            else XB_SPIN(xb_ld(&bar[XB_TOPGEN]) == tg, bar);
            __builtin_amdgcn_fence(__ATOMIC_ACQUIRE, "agent");
            xb_add(&bar[XB_XGEN(b.x)], 1u);
            asm volatile("s_waitcnt vmcnt(0)" ::: "memory");
        } else {
            XB_SPIN(xb_ld(&bar[XB_XGEN(b.x)]) == gen, bar);
            __builtin_amdgcn_fence(__ATOMIC_ACQUIRE, "agent");
            asm volatile("s_waitcnt vmcnt(0)" ::: "memory");
        }
    }
    __syncthreads();
}

struct Params {
    const float* in[23];
    float* out;
    unsigned char* ws;
    int ph_lo, ph_hi;
    int use_bar, pad;
};

constexpr int PH_TOTAL = 3 + 5 * DEPTH;

__device__ __forceinline__ void transpose_item(const float* W, int N, int k0, int n0, bf16_t* WT, int ldt, int dstrow0, LAS float* scr, int lane) {
#pragma unroll 8
    for (int i = 0; i < 32; ++i) { const int kk = 2 * i + (lane >> 5); scr[kk * 33 + (lane & 31)] = W[(size_t)(k0 + kk) * N + n0 + (lane & 31)]; }
    LDS_WAIT(); asm volatile("" ::: "memory");
    const int c = lane & 7;
#pragma unroll
    for (int j = 0; j < 4; ++j) { const int n = (lane >> 3) + 8 * j; const LAS float* s = scr + (8 * c) * 33 + n;
        u32x4 o; o.x = pk2(s[0 * 33], s[1 * 33]); o.y = pk2(s[2 * 33], s[3 * 33]); o.z = pk2(s[4 * 33], s[5 * 33]); o.w = pk2(s[6 * 33], s[7 * 33]);
        *(u32x4*)(WT + (size_t)(dstrow0 + n) * ldt + k0 + 8 * c) = o; }
    LDS_WAIT(); asm volatile("" ::: "memory");
}

__device__ __forceinline__ int split_slot_off(int s) {
    const int bj = (s == 1 || s == 4 || s == 5 || s == 7) ? 1 : 0;
    const int wc = (s == 0 || s == 1) ? 2 : (s == 2 || s == 4) ? 0 : (s == 3 || s == 5) ? 1 : 3;
    return 128 * bj + 32 * wc;
}

__device__ __forceinline__ void phase_prologue(const Params& p, unsigned char* ws, LAS unsigned char* lds, int vcu, int G, int wave, int lane) {
    LAS float* scr = (LAS float*)(lds + wave * 16384);
    const int gw = vcu * NWAVES + wave, NGW = G * NWAVES;
    bf16_t* WCt = (bf16_t*)(ws + WS_WC); bf16_t* WINt = (bf16_t*)(ws + WS_WIN);
    bf16_t* WAt = (bf16_t*)(ws + WS_WA); bf16_t* WBt = (bf16_t*)(ws + WS_WB); bf16_t* WOt = (bf16_t*)(ws + WS_WO);
    bf16_t* WRI = (bf16_t*)(ws + WS_WRI);
    constexpr int I_WC = 16 * 96, I_WIN = 16 * 256, I_SQ = 16 * 32, I_G = 2 * 4;
    constexpr int N_WC = DEPTH * I_WC, N_WIN = DEPTH * I_WIN, N_SQ = DEPTH * 3 * I_SQ, N_G = DEPTH * 2 * 8 * I_G;
    constexpr int NITEMS = N_WC + N_WIN + N_SQ + N_G;
    for (int it = gw; it < NITEMS; it += NGW) {
        int r = it;
        if (r < N_WIN) {
            const int l = r / I_WIN, q = r % I_WIN, kb = q / 256, nb = q % 256, n0 = nb * 32;
            const int s = n0 >> 10, ch0 = n0 & 1023, pn = ch0 >> 5;
            transpose_item(p.in[9] + (size_t)l * D * NIN, NIN, kb * 64, n0, WINt + (size_t)l * NIN * D, D, 256 * pn + split_slot_off(s), scr, lane);
            continue;
        }
        r -= N_WIN;
        if (r < N_WC) {
            const int l = r / I_WC, q = r % I_WC, kb = q / 96, nb = q % 96;
            transpose_item(p.in[7] + (size_t)l * D * 3072, 3072, kb * 64, nb * 32, WCt, D, l * 3072 + nb * 32, scr, lane);
            continue;
        }
        r -= N_WC;
        if (r < N_SQ) {
            const int mat = r / (DEPTH * I_SQ), q2 = r % (DEPTH * I_SQ), l = q2 / I_SQ, q = q2 % I_SQ, kb = q / 32, nb = q % 32;
            const float* W = p.in[18 + mat] + (size_t)l * D * D;
            bf16_t* WT = (mat == 0 ? WAt : mat == 1 ? WBt : WOt) + (size_t)l * D * D;
            transpose_item(W, D, kb * 64, nb * 32, WT, D, nb * 32, scr, lane);
            continue;
        }
        r -= N_SQ;
        {
            const int mtx = r / I_G, q = r % I_G, kb = q / 4, nb = q % 4;
            const int l = mtx / 16, gate = (mtx / 8) & 1, hb = mtx & 7;
            const float* W = p.in[gate ? 14 : 12] + ((size_t)l * 8 + hb) * 128 * 128;
            bf16_t* WT = WRI + (((size_t)l * 2 + gate) * 8 + hb) * 128 * 128;
            transpose_item(W, 128, kb * 64, nb * 32, WT, 128, nb * 32, scr, lane);
        }
    }
    bf16_t* CS = (bf16_t*)(ws + WS_CS);
    const int gt = (vcu * NWAVES + wave) * 64 + lane, NT = G * NWAVES * 64;
    for (int i = gt; i < 256 * D / 4; i += NT) {
        const int row = (i * 4) / D, col = (i * 4) % D;
        f32x4 v = (f32x4){0.f, 0.f, 0.f, 0.f};
        if (row < NB) v = *(const f32x4*)(p.in[5] + (size_t)row * D + col);
        else if (row < NB + NQ) v = *(const f32x4*)(p.in[6] + (size_t)(row - NB) * D + col);
        u32x2 o; o.x = pk2(silu_f(v[0]), silu_f(v[1])); o.y = pk2(silu_f(v[2]), silu_f(v[3]));
        *(u32x2*)(CS + (size_t)row * D + col) = o;
    }
}

__device__ __forceinline__ void ln_mod_row(const f32x4 (&v)[4], const float* mod_l, int mrow, bf16_t* hrow, int lane) {
    float s = 0.f;
#pragma unroll
    for (int j = 0; j < 4; ++j) s += (v[j][0] + v[j][1]) + (v[j][2] + v[j][3]);
    const float mean = wave_sum(s) * (1.f / D); float s2 = 0.f;
    f32x4 d[4];
#pragma unroll
    for (int j = 0; j < 4; ++j) { d[j] = v[j] - mean; s2 += (d[j][0] * d[j][0] + d[j][1] * d[j][1]) + (d[j][2] * d[j][2] + d[j][3] * d[j][3]); }
    const float rstd = 1.f / sqrtf(wave_sum(s2) * (1.f / D) + LN_EPS);
    const float* mr = mod_l + (size_t)mrow * 12288;
#pragma unroll
    for (int j = 0; j < 4; ++j) {
        const int c = 4 * lane + 256 * j;
        const f32x4 sh = *(const f32x4*)(mr + c), sc = *(const f32x4*)(mr + 1024 + c);
        const f32x4 o = d[j] * rstd * (1.0f + sc) + sh;
        u32x2 w; w.x = pk2(o[0], o[1]); w.y = pk2(o[2], o[3]);
        *(u32x2*)(hrow + c) = w;
    }
}
__device__ __forceinline__ int mod_row_of(int r) { return r < MP ? (r >> 11) : (NB + ((r - MP) >> 2)); }

__device__ __forceinline__ void phase_h0(const Params& p, unsigned char* ws, int vcu, int G, int wave, int lane) {
    const int gw = vcu * NWAVES + wave, NGW = G * NWAVES;
    const float* MOD = (const float*)(ws + WS_MOD);
    bf16_t* H = (bf16_t*)(ws + WS_H);
    for (int r = gw; r < M; r += NGW) {
        const float* xr = r < MP ? p.in[0] + (size_t)r * D : p.in[1] + (size_t)(r - MP) * D;
        f32x4 v[4];
#pragma unroll
        for (int j = 0; j < 4; ++j) v[j] = *(const f32x4*)(xr + 4 * lane + 256 * j);
        ln_mod_row(v, MOD, mod_row_of(r), H + (size_t)r * D, lane);
    }
}
__device__ __forceinline__ void phase_ln(const Params& p, unsigned char* ws, int l, int vcu, int G, int wave, int lane) {
    const int gw = vcu * NWAVES + wave, NGW = G * NWAVES;
    const float* MOD = (const float*)(ws + WS_MOD);
    const float* RES = (const float*)(ws + WS_U + 4 * ACT_BYTES);
    bf16_t* H = (bf16_t*)(ws + WS_H);
    const float* lg = p.in[21] + (size_t)l * D; const float* lb = p.in[22] + (size_t)l * D;
    for (int r = gw; r < M; r += NGW) {
        const float* xr = RES + (size_t)r * D;
        f32x4 v[4]; float s = 0.f;
#pragma unroll
        for (int j = 0; j < 4; ++j) { v[j] = *(const f32x4*)(xr + 4 * lane + 256 * j); s += (v[j][0] + v[j][1]) + (v[j][2] + v[j][3]); }
        const float mean = wave_sum(s) * (1.f / D); float s2 = 0.f;
#pragma unroll
        for (int j = 0; j < 4; ++j) { v[j] = v[j] - mean; s2 += (v[j][0] * v[j][0] + v[j][1] * v[j][1]) + (v[j][2] * v[j][2] + v[j][3] * v[j][3]); }
        const float rstd = 1.f / sqrtf(wave_sum(s2) * (1.f / D) + LN_EPS);
#pragma unroll
        for (int j = 0; j < 4; ++j) {
            const int c = 4 * lane + 256 * j;
            v[j] = v[j] * rstd * *(const f32x4*)(lg + c) + *(const f32x4*)(lb + c);
            *(f32x4*)(p.out + O_Y + (size_t)r * D + c) = v[j];
        }
        if (l + 1 < DEPTH) ln_mod_row(v, MOD + (size_t)(l + 1) * 3072, mod_row_of(r), H + (size_t)r * D, lane);
    }
}

constexpr int XA_STRIDE = 272;
constexpr int XA_BYTES = 256 * XA_STRIDE;
constexpr int COMP_OFF = XA_BYTES;
constexpr int BF_OFF = COMP_OFF + 4096;

__device__ __forceinline__ void phase_scan(const Params& p, unsigned char* ws, int l, LAS unsigned char* lds, int G, int tid, int wave, int lane) {
    const bf16_t* AX = (const bf16_t*)(ws + WS_U);
    bf16_t* A1 = (bf16_t*)(ws + WS_U + 1 * ACT_BYTES);
    const bf16_t* V = (const bf16_t*)(ws + WS_U + 2 * ACT_BYTES);
    bf16_t* A2 = (bf16_t*)(ws + WS_U + 3 * ACT_BYTES);
    const bf16_t* WRI = (const bf16_t*)(ws + WS_WRI);
    const float* caw = p.in[10] + (size_t)l * 4 * D; const float* cab = p.in[11] + (size_t)l * D;
    const float* st_h = p.in[2] + (size_t)l * NQ * D; const float* st_ca = p.in[3] + (size_t)l * NQ * 3 * D; const float* st_cb = p.in[4] + (size_t)l * NQ * 2 * D;
    float* o_hp = p.out + O_HP + (size_t)l * NB * D; float* o_hs = p.out + O_HS + (size_t)l * NQ * D;
    typedef float f32x2v __attribute__((ext_vector_type(2)));
    LAS f32x2v* COMP = (LAS f32x2v*)(lds + COMP_OFF);
    const int c = lane & 31, hh = lane >> 5;

    for (int task = blockIdx.x; task < 256 + 64; task += G) {
        const bool sample = task >= 256;
        int hb, ct, nchunks, row_base, sidx;
        if (!sample) { sidx = task >> 5; hb = (task >> 2) & 7; ct = task & 3; nchunks = SEQ / 256; row_base = sidx * SEQ; }
        else { const int tt = task - 256; sidx = tt >> 5; hb = (tt >> 2) & 7; ct = tt & 3; nchunks = 1; row_base = MP + sidx * 256; }
        const int cp = tid & 15, chs = 128 * hb + 8 * cp;
        float cw[4][8], cb8[8];
#pragma unroll
        for (int k = 0; k < 4; ++k) { const f32x4 a = *(const f32x4*)(caw + (size_t)k * D + chs), b = *(const f32x4*)(caw + (size_t)k * D + chs + 4);
#pragma unroll
            for (int j = 0; j < 4; ++j) { cw[k][j] = a[j]; cw[k][4 + j] = b[j]; } }
        { const f32x4 a = *(const f32x4*)(cab + chs), b = *(const f32x4*)(cab + chs + 4);
#pragma unroll
            for (int j = 0; j < 4; ++j) { cb8[j] = a[j]; cb8[4 + j] = b[j]; } }
        const int ch = 128 * hb + 32 * ct + c;
        const float br = p.in[13][(size_t)l * D + ch], bi = p.in[15][(size_t)l * D + ch];
        const float lam = p.in[16][(size_t)l * D + ch];
        const float sp = (lam < -20.f) ? -lam : log1pf(expf(-lam));
        const float kexp = -8.0f * LOG2E * sp;
        { const bf16_t* wsrc = WRI + ((((size_t)l * 2) * 8 + hb) * 128 + 32 * ct + c) * 128 + 8 * hh + 16 * wave;
          const bf16x8 fr_ = *(const bf16x8*)wsrc, fi_ = *(const bf16x8*)(wsrc + (size_t)8 * 128 * 128);
          *(LAS bf16x8*)(lds + BF_OFF + ((0 * 8 + wave) * 64 + lane) * 16) = fr_;
          *(LAS bf16x8*)(lds + BF_OFF + ((1 * 8 + wave) * 64 + lane) * 16) = fi_; }
        float Hst = 0.f;

        for (int j = 0; j < nchunks; ++j) {
            const int buf = j & 1;
#pragma unroll 2
            for (int i = 0; i < 8; ++i) {
                const int pidx = tid + 512 * i, row = pidx >> 4;
                float xa[8];
#pragma unroll
                for (int q = 0; q < 8; ++q) xa[q] = cb8[q];
                if (!sample) {
                    const int t = 256 * j + row;
#pragma unroll
                    for (int d = 0; d < 4; ++d) {
                        const int tt = t - 3 + d;
                        if (tt >= 0) {
                            const u32x4 w = *(const u32x4*)(AX + (size_t)(row_base + tt) * D + chs);
                            xa[0] += cw[d][0] * bf_lo(w.x); xa[1] += cw[d][1] * bf_hi(w.x); xa[2] += cw[d][2] * bf_lo(w.y); xa[3] += cw[d][3] * bf_hi(w.y);
                            xa[4] += cw[d][4] * bf_lo(w.z); xa[5] += cw[d][5] * bf_hi(w.z); xa[6] += cw[d][6] * bf_lo(w.w); xa[7] += cw[d][7] * bf_hi(w.w);
                        }
                    }
                } else {
                    const int gr = row_base + row, t = row & 3, q_ = (gr - MP) >> 2;
#pragma unroll
                    for (int d = 0; d < 4; ++d) {
                        const int tt = t - 3 + d;
                        if (tt >= 0) {
                            const u32x4 w = *(const u32x4*)(AX + (size_t)(gr - t + tt) * D + chs);
                            xa[0] += cw[d][0] * bf_lo(w.x); xa[1] += cw[d][1] * bf_hi(w.x); xa[2] += cw[d][2] * bf_lo(w.y); xa[3] += cw[d][3] * bf_hi(w.y);
                            xa[4] += cw[d][4] * bf_lo(w.z); xa[5] += cw[d][5] * bf_hi(w.z); xa[6] += cw[d][6] * bf_lo(w.w); xa[7] += cw[d][7] * bf_hi(w.w);
                        } else {
                            const float* hp = st_ca + ((size_t)q_ * 3 + (3 + tt)) * D + chs;
                            const f32x4 a = *(const f32x4*)hp, b = *(const f32x4*)(hp + 4);
#pragma unroll
                            for (int q = 0; q < 4; ++q) { xa[q] += cw[d][q] * a[q]; xa[4 + q] += cw[d][4 + q] * b[q]; }
                        }
                    }
                }
                u32x4 o; o.x = pk2(xa[0], xa[1]); o.y = pk2(xa[2], xa[3]); o.z = pk2(xa[4], xa[5]); o.w = pk2(xa[6], xa[7]);
                *(LAS u32x4*)(lds + row * XA_STRIDE + cp * 16) = o;
            }
            __syncthreads();
            f32x16 ar, ai_;
#pragma unroll
            for (int g = 0; g < 16; ++g) { ar[g] = 0.f; ai_[g] = 0.f; }
            {
                const LAS unsigned char* abase = lds + (32 * wave + c) * XA_STRIDE + 16 * hh;
#pragma unroll
                for (int ks = 0; ks < 8; ++ks) {
                    const bf16x8 af = *(const LAS bf16x8*)(abase + 32 * ks);
                    const bf16x8 bfr = *(const LAS bf16x8*)(lds + BF_OFF + ((0 * 8 + ks) * 64 + lane) * 16);
                    const bf16x8 bfi = *(const LAS bf16x8*)(lds + BF_OFF + ((1 * 8 + ks) * 64 + lane) * 16);
                    ar = __builtin_amdgcn_mfma_f32_32x32x16_bf16(af, bfr, ar, 0, 0, 0);
                    ai_ = __builtin_amdgcn_mfma_f32_32x32x16_bf16(af, bfi, ai_, 0, 0, 0);
                }
            }
            float av[16], bv[16];
            unsigned short sz[16];
            const int grow0 = row_base + 256 * j + 32 * wave;
#pragma unroll
            for (int g = 0; g < 16; ++g) {
                const int rw = (g & 3) + 8 * (g >> 2) + 4 * hh;
                const float x = __builtin_bit_cast(float, (unsigned)(*(const LAS unsigned short*)(lds + (32 * wave + rw) * XA_STRIDE + (32 * ct + c) * 2)) << 16);
                sz[g] = A1[(size_t)(grow0 + rw) * D + ch];
                const float rg = sigmoid_f(ar[g] + br), ig = sigmoid_f(ai_[g] + bi);
                const float a = __builtin_amdgcn_exp2f(kexp * rg);
                const float m2 = fmaxf(1.0f - a * a, 0.f);
                av[g] = a; bv[g] = __builtin_amdgcn_sqrtf(m2) * ig * x;
            }
            float RA[4], RB[4];
#pragma unroll
            for (int q = 0; q < 4; ++q) {
                const int g0 = 4 * q;
                float hl = bv[g0], P = av[g0];
#pragma unroll
                for (int k = 1; k < 4; ++k) { hl = av[g0 + k] * hl + bv[g0 + k]; P = av[g0 + k] * P; bv[g0 + k] = hl; av[g0 + k] = P; }
                RA[q] = P; RB[q] = hl;
            }
            float carry[4];
            if (!sample) {
                float KA[8], KB[8];
#pragma unroll
                for (int q = 0; q < 4; ++q) {
                    const float oa = __shfl_xor(RA[q], 32), ob = __shfl_xor(RB[q], 32);
                    KA[2 * q] = hh ? oa : RA[q]; KB[2 * q] = hh ? ob : RB[q];
                    KA[2 * q + 1] = hh ? RA[q] : oa; KB[2 * q + 1] = hh ? RB[q] : ob;
                }
                float cA = 1.f, cB = 0.f;
#pragma unroll
                for (int k = 0; k < 8; ++k) { cB = KA[k] * cB + KB[k]; cA *= KA[k]; }
                if (hh == 0) COMP[(buf * 8 + wave) * 32 + c] = (f32x2v){cA, cB};
                LDS_WAIT();
                __syncthreads();
                float cin = Hst, hall = Hst;
#pragma unroll
                for (int w = 0; w < 8; ++w) {
                    const f32x2v cc = COMP[(buf * 8 + w) * 32 + c];
                    hall = cc.x * hall + cc.y;
                    if (w < wave) cin = hall;
                }
                Hst = hall;
                float cr = cin;
#pragma unroll
                for (int k = 0; k < 8; ++k) { if ((k & 1) == hh) carry[k >> 1] = cr; cr = KA[k] * cr + KB[k]; }
            } else {
                const int seq0 = (row_base - MP) / 4 + 8 * wave + hh;
#pragma unroll
                for (int q = 0; q < 4; ++q) carry[q] = st_h[(size_t)(seq0 + 2 * q) * D + ch];
                __syncthreads();
            }
#pragma unroll
            for (int g = 0; g < 16; ++g) {
                const int rw = (g & 3) + 8 * (g >> 2) + 4 * hh;
                const float h = bv[g] + av[g] * carry[g >> 2];
                const float szf = __builtin_bit_cast(float, (unsigned)sz[g] << 16);
                A1[(size_t)(grow0 + rw) * D + ch] = (bf16_t)f2bf(h * szf);
                if (sample) { if ((g & 3) == 3) o_hs[(size_t)((row_base - MP) / 4 + 8 * wave + 2 * (g >> 2) + hh) * D + ch] = h; }
                else if (j == nchunks - 1 && wave == 7 && hh == 1 && g == 15) o_hp[(size_t)sidx * D + ch] = h;
            }
        }
        __syncthreads();
    }

    {
        const float* cbw = p.in[17] + (size_t)l * 3 * D;
        const int gt = blockIdx.x * 512 + tid, NT = G * 512;
        for (int pidx = gt; pidx < M * 128; pidx += NT) {
            const int r = pidx >> 7, c8 = (pidx & 127) * 8;
            float w0[8], w1[8], w2[8];
            { const f32x4 a = *(const f32x4*)(cbw + c8), b = *(const f32x4*)(cbw + c8 + 4), c_ = *(const f32x4*)(cbw + D + c8), d = *(const f32x4*)(cbw + D + c8 + 4), e = *(const f32x4*)(cbw + 2 * D + c8), f = *(const f32x4*)(cbw + 2 * D + c8 + 4);
#pragma unroll
              for (int q = 0; q < 4; ++q) { w0[q] = a[q]; w0[4 + q] = b[q]; w1[q] = c_[q]; w1[4 + q] = d[q]; w2[q] = e[q]; w2[4 + q] = f[q]; } }
            float y[8];
            { const u32x4 w = *(const u32x4*)(V + (size_t)r * D + c8);
              y[0] = w2[0] * bf_lo(w.x); y[1] = w2[1] * bf_hi(w.x); y[2] = w2[2] * bf_lo(w.y); y[3] = w2[3] * bf_hi(w.y);
              y[4] = w2[4] * bf_lo(w.z); y[5] = w2[5] * bf_hi(w.z); y[6] = w2[6] * bf_lo(w.w); y[7] = w2[7] * bf_hi(w.w); }
            const int t = r < MP ? (r & (SEQ - 1)) : ((r - MP) & 3);
#pragma unroll
            for (int d = 1; d <= 2; ++d) {
                const float* wd = d == 1 ? w1 : w0;
                if (t - d >= 0) {
                    const u32x4 w = *(const u32x4*)(V + (size_t)(r - d) * D + c8);
                    y[0] += wd[0] * bf_lo(w.x); y[1] += wd[1] * bf_hi(w.x); y[2] += wd[2] * bf_lo(w.y); y[3] += wd[3] * bf_hi(w.y);
                    y[4] += wd[4] * bf_lo(w.z); y[5] += wd[5] * bf_hi(w.z); y[6] += wd[6] * bf_lo(w.w); y[7] += wd[7] * bf_hi(w.w);
                } else if (r >= MP) {
                    const float* hp = st_cb + ((size_t)((r - MP) >> 2) * 2 + (2 + t - d)) * D + c8;
                    const f32x4 a = *(const f32x4*)hp, b = *(const f32x4*)(hp + 4);
#pragma unroll
                    for (int q = 0; q < 4; ++q) { y[q] += wd[q] * a[q]; y[4 + q] += wd[4 + q] * b[q]; }
                }
            }
            const u32x4 g = *(const u32x4*)(A2 + (size_t)r * D + c8);
            u32x4 o; o.x = pk2(y[0] * bf_lo(g.x), y[1] * bf_hi(g.x)); o.y = pk2(y[2] * bf_lo(g.y), y[3] * bf_hi(g.y));
            o.z = pk2(y[4] * bf_lo(g.z), y[5] * bf_hi(g.z)); o.w = pk2(y[6] * bf_lo(g.w), y[7] * bf_hi(g.w));
            *(u32x4*)(A2 + (size_t)r * D + c8) = o;
        }
    }
}

__global__ void __launch_bounds__(NWAVES * 64, 2) trunk_fwd(Params p) {
    extern __shared__ __attribute__((aligned(16))) unsigned char lds_raw[];
    LAS unsigned char* lds = (LAS unsigned char*)lds_raw;
    const int G = gridDim.x, bx = blockIdx.x;
    const int vcu = (G % 8 == 0) ? (bx % 8) * (G / 8) + bx / 8 : bx;
    volatile LAS unsigned* MISC = (volatile LAS unsigned*)(lds + 131072 + 320);
    if (threadIdx.x < 32) MISC[threadIdx.x] = 0u;
    __syncthreads();
    XcdBarrier bar; bar.bar = (unsigned*)(p.ws + WS_CTL) + 4096; bar.x = 0; bar.st = nullptr;
    if (p.use_bar) bar = xcd_barrier_post((unsigned*)(p.ws + WS_CTL) + 4096, MISC + 8);

    for (int ph = p.ph_lo; ph < p.ph_hi; ++ph) {
        int tid = threadIdx.x; asm volatile("" : "+v"(tid));
        unsigned char* ws = p.ws; asm volatile("" : "+s"(ws));
        const int lane = tid & 63, wave = __builtin_amdgcn_readfirstlane(tid >> 6);
        if (ph == 0) {
            phase_prologue(p, ws, lds, vcu, G, wave, lane);
        } else if (ph == 1) {
            pg8::Gemm g; g.A0 = g.A1 = (const bf16_t*)(ws + WS_CS); g.B0 = g.B1 = (const bf16_t*)(ws + WS_WC); g.lda = D; g.ldb = D; g.K = D;
            pg8::StaticOrder S; S.init(256, 12288, G, bx, 1);
            EpiMod E{(float*)(ws + WS_MOD), 12288, p.in[8]};
            pg8::gemm_phase<EpiMod, false, false>(lds, g, S, E, tid);
        } else if (ph == 2) {
            phase_h0(p, ws, vcu, G, wave, lane);
        } else {
            const int l = (ph - 3) / 5, sub = (ph - 3) % 5;
            bf16_t* U = (bf16_t*)(ws + WS_U);
            const size_t AE = ACT_BYTES / 2;
            if (sub == 0) {
                pg8::Gemm g; g.A0 = g.A1 = (const bf16_t*)(ws + WS_H); g.B0 = g.B1 = (const bf16_t*)(ws + WS_WIN) + (size_t)l * NIN * D; g.lda = D; g.ldb = D; g.K = D;
                pg8::StaticOrder S; S.init(M, NIN, G, bx, 1);
                EpiG1 E{U, U + AE, U + 2 * AE, U + 3 * AE, U + 4 * AE, U + 5 * AE,
                        p.out + O_CAP + (size_t)l * NB * 3 * D, p.out + O_CBP + (size_t)l * NB * 2 * D, p.out + O_CAS + (size_t)l * NQ * 3 * D, p.out + O_CBS + (size_t)l * NQ * 2 * D};
                pg8::gemm_phase<EpiG1, true, true>(lds, g, S, E, tid);
            } else if (sub == 1) {
                phase_scan(p, ws, l, lds, G, tid, wave, lane);
            } else if (sub == 2) {
                pg8::Gemm g; g.A0 = U + AE; g.A1 = U + 3 * AE; g.B0 = (const bf16_t*)(ws + WS_WA) + (size_t)l * D * D; g.B1 = (const bf16_t*)(ws + WS_WB) + (size_t)l * D * D; g.lda = D; g.ldb = D; g.K = D;
                pg8::StaticOrder S; S.init(M, D, G, bx, 2);
                EpiG3 E{U + 4 * AE, U + 5 * AE, U  };
                pg8::gemm_phase<EpiG3, true, true>(lds, g, S, E, tid);
            } else if (sub == 3) {
                pg8::Gemm g; g.A0 = g.A1 = U; g.B0 = g.B1 = (const bf16_t*)(ws + WS_WO) + (size_t)l * D * D; g.lda = D; g.ldb = D; g.K = D;
                pg8::StaticOrder S; S.init(M, D, G, bx, 1);
                const float* Xp = l == 0 ? p.in[0] : p.out + O_Y; const float* Xs = l == 0 ? p.in[1] : p.out + O_Y + (size_t)MP * D;
                EpiG4 E{Xp, Xs, (const float*)(ws + WS_MOD) + (size_t)l * 3072 + 2048, (float*)(ws + WS_U + 4 * ACT_BYTES)};
                pg8::gemm_phase<EpiG4, true, true>(lds, g, S, E, tid);
            } else {
                phase_ln(p, ws, l, vcu, G, wave, lane);
            }
        }
        if (p.use_bar && ph + 1 < p.ph_hi) xcd_barrier(bar);
    }
}

extern "C" void kernel_launch(void* const* d_in, const int* in_sizes, int n_in, void* d_out, int out_size, void* d_ws, size_t ws_size, hipStream_t stream) {
    static int grid = 0;
    if (grid == 0) {
        if (n_in != 23 || out_size != (int)O_END || ws_size < WS_END) { fprintf(stderr, "kernel_launch: unexpected shapes (n_in %d out %d ws %zu)\n", n_in, out_size, ws_size); grid = -1; return; }
        int dev = 0, cus = 0, per_cu = 0;
        if (hipGetDevice(&dev) != hipSuccess || hipDeviceGetAttribute(&cus, hipDeviceAttributeMultiprocessorCount, dev) != hipSuccess) { grid = -1; return; }
        if (hipFuncSetAttribute((const void*)trunk_fwd, hipFuncAttributeMaxDynamicSharedMemorySize, LDS_BYTES) != hipSuccess) { fprintf(stderr, "kernel_launch: hipFuncSetAttribute failed\n"); grid = -1; return; }
        if (hipOccupancyMaxActiveBlocksPerMultiprocessor(&per_cu, (const void*)trunk_fwd, NWAVES * 64, LDS_BYTES) != hipSuccess || per_cu < 1) { fprintf(stderr, "kernel_launch: occupancy query says %d\n", per_cu); }
        (void)hipGetLastError();
        grid = cus;
    }
    if (grid < 0) return;
    (void)hipMemsetAsync((char*)d_ws + WS_CTL, 0, CTL_ZERO_BYTES, stream);
    Params p{};
    for (int i = 0; i < 23; ++i) p.in[i] = (const float*)d_in[i];
    p.out = (float*)d_out; p.ws = (unsigned char*)d_ws;
#if MK_ONE_LAUNCH
    p.ph_lo = 0; p.ph_hi = PH_TOTAL; p.use_bar = 1;
    hipLaunchKernelGGL(trunk_fwd, dim3(grid), dim3(NWAVES * 64), LDS_BYTES, stream, p);
#else
    for (int ph = 0; ph < PH_TOTAL; ++ph) {
        p.ph_lo = ph; p.ph_hi = ph + 1; p.use_bar = 0;
        hipLaunchKernelGGL(trunk_fwd, dim3(grid), dim3(NWAVES * 64), LDS_BYTES, stream, p);
    }
#endif
}
```
